# Optimizing an MI355X kernel written in HIP

```python
import math
import jax, jax.numpy as jnp
from jax import lax
import numpy as np

D_MODEL = 1024
BATCH = 2
SEQ = 8192
DEPTH = 1

D_RNN = D_MODEL // 2
N_RNN_BLOCKS = 8
RNN_BLOCK = D_RNN // N_RNN_BLOCKS
CONV_WIDTH = 4
CONV_LEFT = 2
LRU_C = 8.0
N_ATTN_HEADS = 8
HEAD_DIM = 64
D_ATTN = N_ATTN_HEADS * HEAD_DIM
DILATED_PATTERNS = ((128, 1), (512, 4), (2048, 16))
Q_BLOCK = 128
N_BUCKETS = 32
MAX_DISTANCE = 1024
D_MIX = D_RNN + D_ATTN
D_IN = 2 * D_RNN + 3 * D_ATTN
D_FF = 4 * D_MODEL
EPS = 1e-6
NEG_INF = -1e30

kernel_name = "hybrid_rglru_dilated_attn_block"


def rms_norm(x, g):
    xf = x.astype(jnp.float32)
    y = xf * lax.rsqrt(jnp.mean(xf * xf, axis=-1, keepdims=True) + EPS)
    return (y * g.astype(jnp.float32)).astype(x.dtype)


def t5_bucket(rel):
    nb = N_BUCKETS // 2
    max_exact = nb // 2
    ret = jnp.where(rel > 0, nb, 0)
    n = jnp.abs(rel)
    nf = jnp.maximum(n, 1).astype(jnp.float32)
    large = max_exact + (jnp.log(nf / max_exact) / math.log(MAX_DISTANCE / max_exact)
                         * (nb - max_exact)).astype(jnp.int32)
    large = jnp.minimum(large, nb - 1)
    return ret + jnp.where(n < max_exact, n, large)


def centred_depthwise_conv(x, w, b):
    S = x.shape[1]
    xp = jnp.pad(x, ((0, 0), (CONV_LEFT, CONV_WIDTH - 1 - CONV_LEFT), (0, 0)))
    y = b
    for k in range(CONV_WIDTH):
        y = y + xp[:, k:k + S] * w[k]
    return y


def rg_lru(x, wa, ba, wx, bx, lam, reverse):
    B, S, _ = x.shape
    xb = x.reshape(B, S, N_RNN_BLOCKS, RNN_BLOCK)
    r = jax.nn.sigmoid((jnp.einsum('bsnc,ncd->bsnd', xb, wa).reshape(B, S, D_RNN) + ba).astype(jnp.float32))
    i = jax.nn.sigmoid((jnp.einsum('bsnc,ncd->bsnd', xb, wx).reshape(B, S, D_RNN) + bx).astype(jnp.float32))
    log_a = -LRU_C * jax.nn.softplus(-lam.astype(jnp.float32)) * r
    a = jnp.exp(log_a)
    b_in = jnp.sqrt(-jnp.expm1(2.0 * log_a)) * (i * x.astype(jnp.float32))

    def combine(c1, c2):
        a1, b1 = c1
        a2, b2 = c2
        return a1 * a2, a2 * b1 + b2

    _, h = lax.associative_scan(combine, (a, b_in), reverse=reverse, axis=1)
    return h


def dilated_attention(q, k, v, rel_bias):
    B, S, H, Dh = q.shape
    nb = S // Q_BLOCK
    scale = Dh ** -0.5
    pats = []
    for window, dil in DILATED_PATTERNS:
        half = window // (2 * dil)
        offs = jnp.arange(-half, half + 1, dtype=jnp.int32) * dil
        bias = rel_bias[t5_bucket(offs)].astype(jnp.float32).T
        pats.append((offs, bias))
    q_blocks = q.reshape(B, nb, Q_BLOCK, H, Dh).transpose(1, 0, 2, 3, 4)

    def one_block(args):
        qb, n = args
        pos = n * Q_BLOCK + jnp.arange(Q_BLOCK, dtype=jnp.int32)
        outs, lses = [], []
        for offs, bias in pats:
            kpos = pos[:, None] + offs[None, :]
            valid = (kpos >= 0) & (kpos < S)
            kidx = jnp.clip(kpos, 0, S - 1)
            kg = k[:, kidx]
            vg = v[:, kidx]
            logits = jnp.einsum('bqhd,bqjhd->bhqj', qb, kg).astype(jnp.float32) * scale
            logits = logits + bias[None, :, None, :]
            logits = jnp.where(valid[None, None], logits, NEG_INF)
            lse = jax.nn.logsumexp(logits, axis=-1)
            p = jnp.exp(logits - lse[..., None])
            outs.append(jnp.einsum('bhqj,bqjhd->bqhd', p.astype(v.dtype), vg).astype(jnp.float32))
            lses.append(lse)
        w = jax.nn.softmax(jnp.stack(lses, axis=0), axis=0)
        w = jnp.transpose(w, (0, 1, 3, 2))[..., None]
        o = jnp.sum(w * jnp.stack(outs, axis=0), axis=0)
        return o.astype(q.dtype)

    out = lax.map(one_block, (q_blocks, jnp.arange(nb, dtype=jnp.int32)))
    return out.transpose(1, 0, 2, 3, 4).reshape(B, S, H * Dh)


def setup_inputs(seed: int = 0) -> dict:
    key = jax.random.key(seed)
    ks = jax.random.split(key, 24)
    f32 = jnp.float32

    def nrm(k, shape, s):
        return jax.random.normal(k, shape, f32) * s

    def gain(k, shape):
        return 1.0 + 0.02 * jax.random.normal(k, shape, f32)

    def lam(k):
        u = jax.random.uniform(k, (DEPTH, D_RNN), f32, minval=0.9, maxval=0.999)
        s = u ** (1.0 / LRU_C)
        return jnp.log(s) - jnp.log1p(-s)

    return {
        "x": jax.random.normal(ks[0], (BATCH, SEQ, D_MODEL), f32),
        "attn_norm_g": gain(ks[1], (DEPTH, D_MODEL)),
        "w_in": nrm(ks[2], (DEPTH, D_MODEL, D_IN), D_MODEL ** -0.5),
        "conv_w": nrm(ks[3], (DEPTH, CONV_WIDTH, D_RNN), CONV_WIDTH ** -0.5),
        "conv_b": nrm(ks[4], (DEPTH, D_RNN), 0.01),
        "lru_wa_fwd": nrm(ks[5], (DEPTH, N_RNN_BLOCKS, RNN_BLOCK, RNN_BLOCK), RNN_BLOCK ** -0.5),
        "lru_ba_fwd": nrm(ks[6], (DEPTH, D_RNN), 0.01),
        "lru_wx_fwd": nrm(ks[7], (DEPTH, N_RNN_BLOCKS, RNN_BLOCK, RNN_BLOCK), RNN_BLOCK ** -0.5),
        "lru_bx_fwd": nrm(ks[8], (DEPTH, D_RNN), 0.01),
        "lru_lam_fwd": lam(ks[9]),
        "lru_wa_bwd": nrm(ks[10], (DEPTH, N_RNN_BLOCKS, RNN_BLOCK, RNN_BLOCK), RNN_BLOCK ** -0.5),
        "lru_ba_bwd": nrm(ks[11], (DEPTH, D_RNN), 0.01),
        "lru_wx_bwd": nrm(ks[12], (DEPTH, N_RNN_BLOCKS, RNN_BLOCK, RNN_BLOCK), RNN_BLOCK ** -0.5),
        "lru_bx_bwd": nrm(ks[13], (DEPTH, D_RNN), 0.01),
        "lru_lam_bwd": lam(ks[14]),
        "rel_bias": nrm(ks[15], (N_BUCKETS, N_ATTN_HEADS), 0.5),
        "norm_rnn_g": gain(ks[16], (DEPTH, D_RNN)),
        "norm_attn_g": gain(ks[17], (DEPTH, D_ATTN)),
        "w_out": nrm(ks[18], (DEPTH, D_MIX, D_MODEL), D_MIX ** -0.5),
        "mlp_norm_g": gain(ks[19], (DEPTH, D_MODEL)),
        "w_up": nrm(ks[20], (DEPTH, D_MODEL, D_FF), D_MODEL ** -0.5),
        "w_down": nrm(ks[21], (DEPTH, D_FF, D_MODEL), D_FF ** -0.5),
        "final_norm_g": gain(ks[22], (D_MODEL,)),
    }


def reference(x, attn_norm_g, w_in, conv_w, conv_b,
              lru_wa_fwd, lru_ba_fwd, lru_wx_fwd, lru_bx_fwd, lru_lam_fwd,
              lru_wa_bwd, lru_ba_bwd, lru_wx_bwd, lru_bx_bwd, lru_lam_bwd,
              rel_bias, norm_rnn_g, norm_attn_g, w_out,
              mlp_norm_g, w_up, w_down, final_norm_g):
    B, S, _ = x.shape
    for l in range(DEPTH):
        h = rms_norm(x, attn_norm_g[l])
        proj = h @ w_in[l]
        xr, gate, q, k, v = jnp.split(
            proj, [D_RNN, 2 * D_RNN, 2 * D_RNN + D_ATTN, 2 * D_RNN + 2 * D_ATTN], axis=-1)
        xr = centred_depthwise_conv(xr, conv_w[l], conv_b[l])
        h_f = rg_lru(xr, lru_wa_fwd[l], lru_ba_fwd[l], lru_wx_fwd[l], lru_bx_fwd[l], lru_lam_fwd[l], False)
        h_b = rg_lru(xr, lru_wa_bwd[l], lru_ba_bwd[l], lru_wx_bwd[l], lru_bx_bwd[l], lru_lam_bwd[l], True)
        y_rnn = (h_f + h_b).astype(x.dtype) * jax.nn.gelu(gate)
        qh = q.reshape(B, S, N_ATTN_HEADS, HEAD_DIM)
        kh = k.reshape(B, S, N_ATTN_HEADS, HEAD_DIM)
        vh = v.reshape(B, S, N_ATTN_HEADS, HEAD_DIM)
        y_attn = dilated_attention(qh, kh, vh, rel_bias)
        mix = jnp.concatenate([rms_norm(y_rnn, norm_rnn_g[l]), rms_norm(y_attn, norm_attn_g[l])], axis=-1)
        x = x + mix @ w_out[l]
        h = rms_norm(x, mlp_norm_g[l])
        x = x + jnp.square(jax.nn.relu(h @ w_up[l])) @ w_down[l]
    return rms_norm(x, final_norm_g)
```

```cpp
#include <hip/hip_runtime.h>
#include <cstdint>
#include <cstdio>

constexpr int BATCH = 2, SEQ = 8192, DM = 1024, M = BATCH * SEQ;
constexpr int DRNN = 512, NBLK = 8, RB = 64, DATT = 512, NH = 8, HD = 64, DIN = 2560, DFF = 4096;
constexpr int NPAT = 3, NJ = 129;
constexpr float EPS = 1e-6f;

typedef unsigned short bf16;
typedef unsigned v4u __attribute__((ext_vector_type(4)));
typedef float f32x4 __attribute__((ext_vector_type(4)));

__device__ __forceinline__ unsigned f2bf(float f) { unsigned u = __builtin_bit_cast(unsigned, f); return (u + 0x7fffu + ((u >> 16) & 1u)) >> 16; }
__device__ __forceinline__ float bf2f(unsigned h) { return __builtin_bit_cast(float, h << 16); }
__device__ __forceinline__ unsigned pk2(float lo, float hi) { return f2bf(lo) | (f2bf(hi) << 16); }

constexpr size_t MiB = 1u << 20;
constexpr size_t WS_CTL = 0;
constexpr size_t WS_WIN = 2 * MiB;
constexpr size_t WS_WOUT = 7 * MiB;
constexpr size_t WS_WUP = 9 * MiB;
constexpr size_t WS_WDN = 17 * MiB;
constexpr size_t WS_WG = 25 * MiB;
constexpr size_t WS_BIAS = 25 * MiB + 512 * 1024;
constexpr size_t WS_MISC = 26 * MiB;
constexpr size_t WS_XN = 32 * MiB;
constexpr size_t WS_MIX = 64 * MiB;
constexpr size_t WS_XR = 96 * MiB;
constexpr size_t WS_GATE = 112 * MiB;
constexpr size_t WS_Q = 128 * MiB;
constexpr size_t WS_K = 144 * MiB;
constexpr size_t WS_V = 160 * MiB;
constexpr size_t WS_H = 96 * MiB;
constexpr size_t WS_HF = 176 * MiB;
constexpr size_t WS_HB = 208 * MiB;
constexpr size_t WS_XC = 240 * MiB;
constexpr size_t WS_YA = 176 * MiB;

__global__ void k_transpose(const float* __restrict__ W, int K, int N, bf16* __restrict__ WT, int ldt, int row_off) {
    __shared__ float t[32][33];
    const int k0 = blockIdx.y * 32, n0 = blockIdx.x * 32, tx = threadIdx.x & 31, ty = threadIdx.x >> 5;
    for (int i = ty; i < 32; i += 8) t[i][tx] = W[(size_t)(k0 + i) * N + n0 + tx];
    __syncthreads();
    for (int i = ty; i < 32; i += 8) WT[(size_t)(row_off + n0 + i) * ldt + k0 + tx] = (bf16)f2bf(t[tx][i]);
}
__global__ void k_gatew(const float* waf, const float* wxf, const float* wab, const float* wxb, bf16* WG) {
    const int idx = blockIdx.x * blockDim.x + threadIdx.x;
    if (idx >= 8 * 256 * 64) return;
    const int c = idx & 63, o = (idx >> 6) & 255, n = idx >> 14, type = o >> 6, d = o & 63;
    const float* w = type == 0 ? waf : type == 1 ? wxf : type == 2 ? wab : wxb;
    WG[idx] = (bf16)f2bf(w[(n * 64 + c) * 64 + d]);
}
__device__ __forceinline__ int t5_bucket(int rel) {
    const int n = rel < 0 ? -rel : rel; int ret = rel > 0 ? 16 : 0;
    if (n < 8) return ret + n;
    int large = 8 + (int)(logf((float)n / 8.0f) / logf(128.0f) * 8.0f);
    large = large < 15 ? large : 15;
    return ret + large;
}
__global__ void k_bias(const float* rel_bias, float* tab) {
    const int idx = blockIdx.x * blockDim.x + threadIdx.x;
    if (idx >= NPAT * NH * NJ) return;
    const int j = idx % NJ, h = (idx / NJ) % NH, p = idx / (NJ * NH);
    const int dil = p == 0 ? 1 : p == 1 ? 4 : 16;
    tab[idx] = rel_bias[t5_bucket((j - 64) * dil) * NH + h];
}
__global__ void k_rmsnorm_bf16(const float* __restrict__ x, const float* __restrict__ g, bf16* __restrict__ out) {
    const int row = blockIdx.x * 4 + (threadIdx.x >> 6), lane = threadIdx.x & 63;
    const f32x4* xr = (const f32x4*)(x + (size_t)row * DM) + lane;
    f32x4 v[4]; float s = 0.f;
#pragma unroll
    for (int j = 0; j < 4; ++j) { v[j] = xr[64 * j]; s += v[j].x * v[j].x + v[j].y * v[j].y + v[j].z * v[j].z + v[j].w * v[j].w; }
#pragma unroll
    for (int o = 1; o < 64; o <<= 1) s += __shfl_xor(s, o);
    const float rstd = 1.0f / sqrtf(s * (1.0f / DM) + EPS);
    unsigned long long* o8 = (unsigned long long*)(out + (size_t)row * DM) + lane;
#pragma unroll
    for (int j = 0; j < 4; ++j) { const f32x4 gg = ((const f32x4*)g)[lane + 64 * j];
        o8[64 * j] = (unsigned long long)pk2(v[j].x * rstd * gg.x, v[j].y * rstd * gg.y) | ((unsigned long long)pk2(v[j].z * rstd * gg.z, v[j].w * rstd * gg.w) << 32); }
}
__global__ void k_rmsnorm_f32(float* __restrict__ x, const float* __restrict__ g) {
    const int row = blockIdx.x * 4 + (threadIdx.x >> 6), lane = threadIdx.x & 63;
    f32x4* xr = (f32x4*)(x + (size_t)row * DM) + lane;
    f32x4 v[4]; float s = 0.f;
#pragma unroll
    for (int j = 0; j < 4; ++j) { v[j] = xr[64 * j]; s += v[j].x * v[j].x + v[j].y * v[j].y + v[j].z * v[j].z + v[j].w * v[j].w; }
#pragma unroll
    for (int o = 1; o < 64; o <<= 1) s += __shfl_xor(s, o);
    const float rstd = 1.0f / sqrtf(s * (1.0f / DM) + EPS);
#pragma unroll
    for (int j = 0; j < 4; ++j) { const f32x4 gg = ((const f32x4*)g)[lane + 64 * j]; xr[64 * j] = v[j] * rstd * gg; }
}

struct EpiProj { bf16* base; __device__ void operator()(int r, int c, float v) const { const int t = c >> 9; base[(size_t)t * ((size_t)M * 512) + (size_t)r * 512 + (c & 511)] = (bf16)f2bf(v); } };
struct EpiX1 { const float* x; float* out; __device__ void operator()(int r, int c, float v) const { out[(size_t)r * DM + c] = x[(size_t)r * DM + c] + v; } };
struct EpiRelu2 { bf16* H; __device__ void operator()(int r, int c, float v) const { const float t = v > 0.f ? v : 0.f; H[(size_t)r * DFF + c] = (bf16)f2bf(t * t); } };
struct EpiAcc { float* out; __device__ void operator()(int r, int c, float v) const { out[(size_t)r * DM + c] += v; } };

template <class Epi>
__global__ void __launch_bounds__(256) k_gemm_simple(const bf16* __restrict__ A, const bf16* __restrict__ Bt, int N, int K, Epi epi) {
    __shared__ float As[16][132], Bs[16][132];
    const int tid = threadIdx.x, tx = tid & 15, ty = tid >> 4;
    const int m0 = blockIdx.y * 128, n0 = blockIdx.x * 128;
    const int lr = tid >> 1, lk = (tid & 1) * 8;
    float acc[8][8];
#pragma unroll
    for (int i = 0; i < 8; ++i)
#pragma unroll
        for (int j = 0; j < 8; ++j) acc[i][j] = 0.f;
    for (int k0 = 0; k0 < K; k0 += 16) {
        const v4u av = *(const v4u*)(A + (size_t)(m0 + lr) * K + k0 + lk);
        const v4u bv = *(const v4u*)(Bt + (size_t)(n0 + lr) * K + k0 + lk);
        __syncthreads();
#pragma unroll
        for (int j = 0; j < 4; ++j) {
            As[lk + 2 * j][lr] = bf2f(av[j] & 0xffffu); As[lk + 2 * j + 1][lr] = bf2f(av[j] >> 16);
            Bs[lk + 2 * j][lr] = bf2f(bv[j] & 0xffffu); Bs[lk + 2 * j + 1][lr] = bf2f(bv[j] >> 16);
        }
        __syncthreads();
#pragma unroll
        for (int kk = 0; kk < 16; ++kk) {
            float a[8], b[8];
#pragma unroll
            for (int i = 0; i < 8; ++i) { a[i] = As[kk][ty * 8 + i]; b[i] = Bs[kk][tx * 8 + i]; }
#pragma unroll
            for (int i = 0; i < 8; ++i)
#pragma unroll
                for (int j = 0; j < 8; ++j) acc[i][j] += a[i] * b[j];
        }
    }
#pragma unroll
    for (int i = 0; i < 8; ++i)
#pragma unroll
        for (int j = 0; j < 8; ++j) epi(m0 + ty * 8 + i, n0 + tx * 8 + j, acc[i][j]);
}

__global__ void k_conv(const bf16* __restrict__ XR, const float* __restrict__ cw, const float* __restrict__ cb, bf16* __restrict__ XC) {
    const size_t idx = (size_t)blockIdx.x * blockDim.x + threadIdx.x;
    const int c = (int)(idx & 511); const int row = (int)(idx >> 9), t = row & (SEQ - 1);
    float y = cb[c];
#pragma unroll
    for (int k = 0; k < 4; ++k) { const int tt = t - 2 + k; if (tt >= 0 && tt < SEQ) y += cw[k * 512 + c] * bf2f(XR[(size_t)(row - 2 + k) * 512 + c]); }
    XC[idx] = (bf16)f2bf(y);
}
__device__ __forceinline__ float sigmoidf(float x) { return 1.0f / (1.0f + __expf(-x)); }
__device__ __forceinline__ float softplusf(float x) { return x > 20.f ? x : log1pf(__expf(x)); }
__global__ void __launch_bounds__(64) k_scan_simple(const bf16* __restrict__ XC, const float* __restrict__ wa_f, const float* __restrict__ ba_f, const float* __restrict__ wx_f, const float* __restrict__ bx_f, const float* __restrict__ lam_f,
                                                    const float* __restrict__ wa_b, const float* __restrict__ ba_b, const float* __restrict__ wx_b, const float* __restrict__ bx_b, const float* __restrict__ lam_b,
                                                    float* __restrict__ HF, float* __restrict__ HB) {
    const int lane = threadIdx.x, n = blockIdx.x & 7, dir = (blockIdx.x >> 3) & 1, b = blockIdx.x >> 4;
    const float* wa = dir ? wa_b : wa_f; const float* wx = dir ? wx_b : wx_f;
    const int ch = n * 64 + lane;
    const float ba = (dir ? ba_b : ba_f)[ch], bx = (dir ? bx_b : bx_f)[ch];
    const float cl = -8.0f * softplusf(-(dir ? lam_b : lam_f)[ch]);
    float* Hout = dir ? HB : HF;
    float wra[64], wrx[64];
#pragma unroll
    for (int c = 0; c < 64; ++c) { wra[c] = wa[(n * 64 + c) * 64 + lane]; wrx[c] = wx[(n * 64 + c) * 64 + lane]; }
    float h = 0.f;
    for (int s = 0; s < SEQ; ++s) {
        const int t = dir ? SEQ - 1 - s : s;
        const size_t off = ((size_t)b * SEQ + t) * 512 + ch;
        const float xc = bf2f(XC[off]);
        float ra = ba, rx = bx;
#pragma unroll
        for (int c = 0; c < 64; ++c) { const float xv = __builtin_bit_cast(float, __builtin_amdgcn_readlane(__builtin_bit_cast(int, xc), c)); ra += xv * wra[c]; rx += xv * wrx[c]; }
        const float r = sigmoidf(ra), i = sigmoidf(rx);
        const float la = cl * r, a = __expf(la), bin = sqrtf(-expm1f(2.0f * la)) * (i * xc);
        h = a * h + bin;
        Hout[off] = h;
    }
}
__device__ __forceinline__ float gelu_tanh(float x) { const float u = 0.7978845608028654f * (x + 0.044715f * x * x * x); return 0.5f * x * (1.0f + tanhf(u)); }
__global__ void __launch_bounds__(512) k_rnn_out(const float* __restrict__ HF, const float* __restrict__ HB, const bf16* __restrict__ GATE, const float* __restrict__ g, bf16* __restrict__ MIX) {
    __shared__ float red[8];
    const int row = blockIdx.x, c = threadIdx.x;
    const size_t off = (size_t)row * 512 + c;
    const float y = (HF[off] + HB[off]) * gelu_tanh(bf2f(GATE[off]));
    float s = y * y;
#pragma unroll
    for (int o = 1; o < 64; o <<= 1) s += __shfl_xor(s, o);
    if ((c & 63) == 0) red[c >> 6] = s;
    __syncthreads();
    float tot = 0.f;
#pragma unroll
    for (int i = 0; i < 8; ++i) tot += red[i];
    const float rstd = 1.0f / sqrtf(tot * (1.0f / 512) + EPS);
    MIX[(size_t)row * DM + c] = (bf16)f2bf(y * rstd * g[c]);
}

__global__ void __launch_bounds__(256) k_attn_simple(const bf16* __restrict__ Q, const bf16* __restrict__ Kb, const bf16* __restrict__ Vb, const float* __restrict__ tab, float* __restrict__ YA) {
    const int gid = blockIdx.x * blockDim.x + threadIdx.x;
    const int h = gid & 7, row = gid >> 3, t = row & (SEQ - 1), b = row >> 13;
    float q[64], o[64];
    {
        const v4u* qp = (const v4u*)(Q + (size_t)row * 512 + h * 64);
#pragma unroll
        for (int i = 0; i < 8; ++i) { const v4u v = qp[i];
#pragma unroll
            for (int j = 0; j < 4; ++j) { q[i * 8 + 2 * j] = bf2f(v[j] & 0xffffu) * 0.125f; q[i * 8 + 2 * j + 1] = bf2f(v[j] >> 16) * 0.125f; } }
    }
#pragma unroll
    for (int i = 0; i < 64; ++i) o[i] = 0.f;
    float m = -1e30f, l = 0.f;
    for (int p = 0; p < NPAT; ++p) {
        const int dil = p == 0 ? 1 : p == 1 ? 4 : 16;
        const float* bt = tab + (p * NH + h) * NJ;
        for (int j = 0; j < NJ; ++j) {
            const int kp = t + (j - 64) * dil;
            if (kp < 0 || kp >= SEQ) continue;
            const size_t koff = ((size_t)b * SEQ + kp) * 512 + h * 64;
            const v4u* kp4 = (const v4u*)(Kb + koff);
            float s = 0.f;
#pragma unroll
            for (int i = 0; i < 8; ++i) { const v4u v = kp4[i];
#pragma unroll
                for (int jj = 0; jj < 4; ++jj) { s += q[i * 8 + 2 * jj] * bf2f(v[jj] & 0xffffu); s += q[i * 8 + 2 * jj + 1] * bf2f(v[jj] >> 16); } }
            s += bt[j];
            const float mn = s > m ? s : m;
            const float f = __expf(m - mn), pe = __expf(s - mn);
            l = l * f + pe;
            const v4u* vp4 = (const v4u*)(Vb + koff);
#pragma unroll
            for (int i = 0; i < 8; ++i) { const v4u v = vp4[i];
#pragma unroll
                for (int jj = 0; jj < 4; ++jj) { o[i * 8 + 2 * jj] = o[i * 8 + 2 * jj] * f + pe * bf2f(v[jj] & 0xffffu); o[i * 8 + 2 * jj + 1] = o[i * 8 + 2 * jj + 1] * f + pe * bf2f(v[jj] >> 16); } }
            m = mn;
        }
    }
    const float inv = 1.0f / l;
    float* yo = YA + (size_t)row * 512 + h * 64;
#pragma unroll
    for (int i = 0; i < 64; ++i) yo[i] = o[i] * inv;
}
__global__ void __launch_bounds__(512) k_attn_out(const float* __restrict__ YA, const float* __restrict__ g, bf16* __restrict__ MIX) {
    __shared__ float red[8];
    const int row = blockIdx.x, c = threadIdx.x;
    const float y = YA[(size_t)row * 512 + c];
    float s = y * y;
#pragma unroll
    for (int o = 1; o < 64; o <<= 1) s += __shfl_xor(s, o);
    if ((c & 63) == 0) red[c >> 6] = s;
    __syncthreads();
    float tot = 0.f;
#pragma unroll
    for (int i = 0; i < 8; ++i) tot += red[i];
    const float rstd = 1.0f / sqrtf(tot * (1.0f / 512) + EPS);
    MIX[(size_t)row * DM + 512 + c] = (bf16)f2bf(y * rstd * g[c]);
}

extern "C" void kernel_launch(void* const* d_in, const int* in_sizes, int n_in, void* d_out, int out_size, void* d_ws, size_t ws_size, hipStream_t stream) {
    if (n_in != 23 || in_sizes[0] != M * DM || out_size != M * DM || ws_size < 256 * MiB) { fprintf(stderr, "kernel_launch: unexpected shapes (n_in %d, in0 %d, out %d, ws %zu)\n", n_in, n_in > 0 ? in_sizes[0] : -1, out_size, ws_size); return; }
    const float* x = (const float*)d_in[0]; const float* attn_g = (const float*)d_in[1]; const float* w_in = (const float*)d_in[2];
    const float* conv_w = (const float*)d_in[3]; const float* conv_b = (const float*)d_in[4];
    const float* wa_f = (const float*)d_in[5]; const float* ba_f = (const float*)d_in[6]; const float* wx_f = (const float*)d_in[7]; const float* bx_f = (const float*)d_in[8]; const float* lam_f = (const float*)d_in[9];
    const float* wa_b = (const float*)d_in[10]; const float* ba_b = (const float*)d_in[11]; const float* wx_b = (const float*)d_in[12]; const float* bx_b = (const float*)d_in[13]; const float* lam_b = (const float*)d_in[14];
    const float* rel_bias = (const float*)d_in[15]; const float* rnn_g = (const float*)d_in[16]; const float* att_g = (const float*)d_in[17];
    const float* w_out = (const float*)d_in[18]; const float* mlp_g = (const float*)d_in[19]; const float* w_up = (const float*)d_in[20]; const float* w_down = (const float*)d_in[21]; const float* fin_g = (const float*)d_in[22];
    unsigned char* ws = (unsigned char*)d_ws; float* out = (float*)d_out;
    bf16* WIN = (bf16*)(ws + WS_WIN); bf16* WOUT = (bf16*)(ws + WS_WOUT); bf16* WUP = (bf16*)(ws + WS_WUP); bf16* WDN = (bf16*)(ws + WS_WDN);
    float* BIAS = (float*)(ws + WS_BIAS);
    bf16* XN = (bf16*)(ws + WS_XN); bf16* MIX = (bf16*)(ws + WS_MIX);
    bf16* XR = (bf16*)(ws + WS_XR); bf16* GATE = (bf16*)(ws + WS_GATE); bf16* Qb = (bf16*)(ws + WS_Q); bf16* Kb = (bf16*)(ws + WS_K); bf16* Vb = (bf16*)(ws + WS_V);
    bf16* Hh = (bf16*)(ws + WS_H); float* HF = (float*)(ws + WS_HF); float* HB = (float*)(ws + WS_HB); bf16* XC = (bf16*)(ws + WS_XC); float* YA = (float*)(ws + WS_YA);

    k_transpose<<<dim3(DIN / 32, DM / 32), 256, 0, stream>>>(w_in, DM, DIN, WIN, DM, 0);
    k_transpose<<<dim3(DM / 32, DM / 32), 256, 0, stream>>>(w_out, DM, DM, WOUT, DM, 0);
    k_transpose<<<dim3(DFF / 32, DM / 32), 256, 0, stream>>>(w_up, DM, DFF, WUP, DM, 0);
    k_transpose<<<dim3(DM / 32, DFF / 32), 256, 0, stream>>>(w_down, DFF, DM, WDN, DFF, 0);
    k_bias<<<(NPAT * NH * NJ + 255) / 256, 256, 0, stream>>>(rel_bias, BIAS);
    k_rmsnorm_bf16<<<M / 4, 256, 0, stream>>>(x, attn_g, XN);
    k_gemm_simple<EpiProj><<<dim3(DIN / 128, M / 128), 256, 0, stream>>>(XN, WIN, DIN, DM, EpiProj{XR});
    k_conv<<<(M * 512) / 256, 256, 0, stream>>>(XR, conv_w, conv_b, XC);
    k_scan_simple<<<BATCH * 2 * NBLK, 64, 0, stream>>>(XC, wa_f, ba_f, wx_f, bx_f, lam_f, wa_b, ba_b, wx_b, bx_b, lam_b, HF, HB);
    k_rnn_out<<<M, 512, 0, stream>>>(HF, HB, GATE, rnn_g, MIX);
    k_attn_simple<<<(M * NH) / 256, 256, 0, stream>>>(Qb, Kb, Vb, BIAS, YA);
    k_attn_out<<<M, 512, 0, stream>>>(YA, att_g, MIX);
    k_gemm_simple<EpiX1><<<dim3(DM / 128, M / 128), 256, 0, stream>>>(MIX, WOUT, DM, DM, EpiX1{x, out});
    k_rmsnorm_bf16<<<M / 4, 256, 0, stream>>>(out, mlp_g, XN);
    k_gemm_simple<EpiRelu2><<<dim3(DFF / 128, M / 128), 256, 0, stream>>>(XN, WUP, DFF, DM, EpiRelu2{Hh});
    k_gemm_simple<EpiAcc><<<dim3(DM / 128, M / 128), 256, 0, stream>>>(Hh, WDN, DM, DFF, EpiAcc{out});
    k_rmsnorm_f32<<<M / 4, 256, 0, stream>>>(out, fin_g);
}
```
